# Optimizing an MI355X kernel written in HIP

```python
import math
import jax
import jax.numpy as jnp
from jax import lax
import numpy as np

D_MODEL = 1024
BATCH = 8
SEQ = 8192
DEPTH = 1
DEC_BATCH = 2
DEC_SEQ = 8192
PAST_LEN = 128

HEAD_DIM = 64
A_GROUPS = ((128, 1), (512, 4), (2048, 16))
A_HEADS_PER_GROUP = 4
A_HEADS = A_HEADS_PER_GROUP * len(A_GROUPS)
A_WIDTH = A_HEADS * HEAD_DIM
A_OUT = A_HEADS_PER_GROUP * HEAD_DIM
A_QBLOCK = 64
B_HEADS = 8
B_WIDTH = B_HEADS * HEAD_DIM
GRID_W = 64
NA_ROWS = 8
NA_COLS = 16
NA_QROWS = 8
NA_QCOLS = 16
ROPE_THETA = 500000.0
ROPE_DIMS = HEAD_DIM // 4
D_FF = 4 * D_MODEL
IN_COLS = 3 * A_WIDTH + 3 * B_WIDTH + 2 * D_MODEL
LN_EPS = 1e-5
DEEPNORM_ALPHA = (2.0 * DEPTH) ** 0.25
DEEPNORM_BETA = (8.0 * DEPTH) ** -0.25
NEG_INF = -1e30

kernel_name = "hybrid_dilated_neighbourhood_encoder"


def layer_norm(x, g, b):
    xf = x.astype(jnp.float32)
    mu = jnp.mean(xf, axis=-1, keepdims=True)
    var = jnp.mean(jnp.square(xf - mu), axis=-1, keepdims=True)
    y = (xf - mu) * lax.rsqrt(var + LN_EPS) * g.astype(jnp.float32) + b.astype(jnp.float32)
    return y.astype(x.dtype)


def partial_rope(x):
    s = x.shape[1]
    half = ROPE_DIMS // 2
    inv = ROPE_THETA ** (-jnp.arange(half, dtype=jnp.float32) / half)
    ang = jnp.arange(s, dtype=jnp.float32)[:, None] * inv[None, :]
    cos = jnp.cos(ang)[None, :, None, :]
    sin = jnp.sin(ang)[None, :, None, :]
    xr = x[..., :ROPE_DIMS].astype(jnp.float32)
    x1, x2 = xr[..., :half], xr[..., half:]
    rot = jnp.concatenate([x1 * cos - x2 * sin, x1 * sin + x2 * cos], axis=-1).astype(x.dtype)
    return jnp.concatenate([rot, x[..., ROPE_DIMS:]], axis=-1)


def dilated_window_attention(q, k, v, window, dilation):
    b, s, h, dh = q.shape
    p = window // (2 * dilation)
    l = s // dilation
    qb = math.gcd(A_QBLOCK, l)
    nb = l // qb
    span = qb + 2 * p

    def to_sub(t):
        return t.reshape(b, l, dilation, h, dh).transpose(0, 2, 1, 3, 4)

    qs = to_sub(q).reshape(b, dilation, nb, qb, h, dh)
    pad = ((0, 0), (0, 0), (p, p), (0, 0), (0, 0))
    ks = jnp.pad(to_sub(k), pad)
    vs = jnp.pad(to_sub(v), pad)
    idx = jnp.arange(nb)[:, None] * qb + jnp.arange(span)[None, :]
    kb = jnp.take(ks, idx, axis=2)
    vb = jnp.take(vs, idx, axis=2)
    scores = jnp.einsum('brnqhd,brnkhd->brnhqk', qs, kb,
                        preferred_element_type=jnp.float32) * (dh ** -0.5)
    off = jnp.arange(span)[None, :] - p - jnp.arange(qb)[:, None]
    key_pos = idx - p
    in_seq = (key_pos >= 0) & (key_pos < l)
    valid = (jnp.abs(off) <= p)[None, :, :] & in_seq[:, None, :]
    scores = jnp.where(valid[None, None, :, None, :, :], scores, NEG_INF)
    m = jnp.max(scores, axis=-1, keepdims=True)
    e = jnp.exp(scores - m)
    den = jnp.sum(e, axis=-1, keepdims=True)
    o = jnp.einsum('brnhqk,brnkhd->brnqhd', e / den, vb.astype(jnp.float32))
    lse = (m + jnp.log(den))[..., 0]
    o = o.reshape(b, dilation, l, h, dh).transpose(0, 2, 1, 3, 4).reshape(b, s, h, dh)
    lse = lse.transpose(0, 1, 2, 4, 3).reshape(b, dilation, l, h).transpose(0, 2, 1, 3).reshape(b, s, h)
    return o, lse


def mixer_a(qa, ka, va):
    qa = partial_rope(qa)
    ka = partial_rope(ka)
    outs, lses = [], []
    for g, (window, dilation) in enumerate(A_GROUPS):
        sl = slice(g * A_HEADS_PER_GROUP, (g + 1) * A_HEADS_PER_GROUP)
        o, lse = dilated_window_attention(qa[:, :, sl], ka[:, :, sl], va[:, :, sl], window, dilation)
        outs.append(o)
        lses.append(lse)
    o = jnp.stack(outs, axis=0)
    w = jax.nn.softmax(jnp.stack(lses, axis=0), axis=0)
    return jnp.sum(w[..., None] * o, axis=0)


def neighbourhood_attention(q, k, v, rpb):
    b, s, h, dh = q.shape
    rows = s // GRID_W
    kh, kw = min(NA_ROWS, rows), NA_COLS
    qr, qc = math.gcd(NA_QROWS, rows), NA_QCOLS
    ksr, ksc = min(qr + kh - 1, rows), min(qc + kw - 1, GRID_W)
    nrb, ncb = rows // qr, GRID_W // qc
    r_idx = jnp.arange(rows)
    c_idx = jnp.arange(GRID_W)
    win_r = jnp.clip(r_idx - kh // 2, 0, rows - kh)
    win_c = jnp.clip(c_idx - kw // 2, 0, GRID_W - kw)
    key_r = jnp.minimum(win_r[::qr], rows - ksr)[:, None] + jnp.arange(ksr)[None, :]
    key_c = jnp.minimum(win_c[::qc], GRID_W - ksc)[:, None] + jnp.arange(ksc)[None, :]

    def gather_kv(t):
        t = t.reshape(b, rows, GRID_W, h, dh)
        t = jnp.take(jnp.take(t, key_r, axis=1), key_c, axis=3)
        return t.transpose(0, 1, 3, 2, 4, 5, 6).reshape(b, nrb, ncb, ksr * ksc, h, dh)

    kg = gather_kv(k)
    vg = gather_kv(v)
    qg = q.reshape(b, nrb, qr, ncb, qc, h, dh).transpose(0, 1, 3, 2, 4, 5, 6).reshape(b, nrb, ncb, qr * qc, h, dh)

    q_r = r_idx.reshape(nrb, qr)
    q_c = c_idx.reshape(ncb, qc)
    wr = win_r.reshape(nrb, qr)[:, :, None]
    wc = win_c.reshape(ncb, qc)[:, :, None]
    kr = key_r[:, None, :]
    kc = key_c[:, None, :]
    ok_r = (kr >= wr) & (kr < wr + kh)
    ok_c = (kc >= wc) & (kc < wc + kw)
    dr = jnp.clip(kr - q_r[:, :, None] + NA_ROWS - 1, 0, 2 * NA_ROWS - 2)
    dc = jnp.clip(kc - q_c[:, :, None] + NA_COLS - 1, 0, 2 * NA_COLS - 2)
    bias = rpb.astype(jnp.float32)[:, dr[:, :, :, None, None, None], dc[None, None, None, :, :, :]]
    ok = ok_r[:, :, :, None, None, None] & ok_c[None, None, None, :, :, :]
    bias = jnp.where(ok[None], bias, NEG_INF)
    bias = bias.transpose(1, 4, 0, 2, 5, 3, 6).reshape(nrb, ncb, h, qr * qc, ksr * ksc)

    scores = jnp.einsum('bnmqhd,bnmkhd->bnmhqk', qg, kg,
                        preferred_element_type=jnp.float32) * (dh ** -0.5) + bias[None]
    probs = jax.nn.softmax(scores, axis=-1)
    o = jnp.einsum('bnmhqk,bnmkhd->bnmqhd', probs, vg.astype(jnp.float32))
    o = o.reshape(b, nrb, ncb, qr, qc, h, dh).transpose(0, 1, 3, 2, 4, 5, 6)
    return o.reshape(b, s, h * dh)


def encoder_layer(x, w_in, b_gate, w_branch_a, w_branch_b, w_out, rpb,
                  ln1_g, ln1_b, w_ff1, b_ff1, w_ff2, b_ff2, ln2_g, ln2_b):
    bsz, seq, _ = x.shape
    proj = jnp.einsum('bsd,df->bsf', x, w_in)
    a, c = A_WIDTH, B_WIDTH
    cuts = [a, 2 * a, 3 * a, 3 * a + c, 3 * a + 2 * c, 3 * a + 3 * c, 3 * a + 3 * c + D_MODEL]
    qa, ka, va, qb, kb, vb, ga, gb = jnp.split(proj, cuts, axis=-1)
    ya = mixer_a(qa.reshape(bsz, seq, A_HEADS, HEAD_DIM),
                 ka.reshape(bsz, seq, A_HEADS, HEAD_DIM),
                 va.reshape(bsz, seq, A_HEADS, HEAD_DIM))
    ya = ya.reshape(bsz, seq, A_OUT).astype(x.dtype) @ w_branch_a
    yb = neighbourhood_attention(qb.reshape(bsz, seq, B_HEADS, HEAD_DIM),
                                 kb.reshape(bsz, seq, B_HEADS, HEAD_DIM),
                                 vb.reshape(bsz, seq, B_HEADS, HEAD_DIM), rpb)
    yb = yb.astype(x.dtype) @ w_branch_b
    merged = jax.nn.sigmoid(ga + b_gate[0]) * ya + jax.nn.sigmoid(gb + b_gate[1]) * yb
    x = layer_norm(DEEPNORM_ALPHA * x + merged @ w_out, ln1_g, ln1_b)
    hid = jnp.square(jax.nn.relu(x @ w_ff1 + b_ff1))
    x = layer_norm(DEEPNORM_ALPHA * x + hid @ w_ff2 + b_ff2, ln2_g, ln2_b)
    return x


def setup_inputs(seed: int = 0) -> dict:
    key = jax.random.key(seed)
    ks = jax.random.split(key, 16)

    def nrm(k, shape, scale):
        return jax.random.normal(k, shape, jnp.float32) * scale

    return {
        'x_prompt': nrm(ks[0], (BATCH, SEQ, D_MODEL), 1.0),
        'x_sample': nrm(ks[1], (DEC_BATCH, DEC_SEQ, D_MODEL), 1.0),
        'w_in': nrm(ks[2], (DEPTH, D_MODEL, IN_COLS), D_MODEL ** -0.5),
        'b_gate': nrm(ks[3], (DEPTH, 2, D_MODEL), 0.1),
        'w_branch_a': nrm(ks[4], (DEPTH, A_OUT, D_MODEL), A_OUT ** -0.5),
        'w_branch_b': nrm(ks[5], (DEPTH, B_WIDTH, D_MODEL), B_WIDTH ** -0.5),
        'w_out': nrm(ks[6], (DEPTH, D_MODEL, D_MODEL), DEEPNORM_BETA * D_MODEL ** -0.5),
        'rel_pos_bias': nrm(ks[7], (DEPTH, B_HEADS, 2 * NA_ROWS - 1, 2 * NA_COLS - 1), 0.1),
        'ln1_g': 1.0 + nrm(ks[8], (DEPTH, D_MODEL), 0.02),
        'ln1_b': nrm(ks[9], (DEPTH, D_MODEL), 0.02),
        'w_ff1': nrm(ks[10], (DEPTH, D_MODEL, D_FF), D_MODEL ** -0.5),
        'b_ff1': nrm(ks[11], (DEPTH, D_FF), 0.02),
        'w_ff2': nrm(ks[12], (DEPTH, D_FF, D_MODEL), DEEPNORM_BETA * D_FF ** -0.5),
        'b_ff2': nrm(ks[13], (DEPTH, D_MODEL), 0.02),
        'ln2_g': 1.0 + nrm(ks[14], (DEPTH, D_MODEL), 0.02),
        'ln2_b': nrm(ks[15], (DEPTH, D_MODEL), 0.02),
    }


def reference(x_prompt, x_sample, w_in, b_gate, w_branch_a, w_branch_b, w_out, rel_pos_bias,
              ln1_g, ln1_b, w_ff1, b_ff1, w_ff2, b_ff2, ln2_g, ln2_b):
    y_prompt = x_prompt
    y_sample = x_sample
    for layer in range(DEPTH):
        p = (w_in[layer], b_gate[layer], w_branch_a[layer], w_branch_b[layer], w_out[layer],
             rel_pos_bias[layer], ln1_g[layer], ln1_b[layer], w_ff1[layer], b_ff1[layer],
             w_ff2[layer], b_ff2[layer], ln2_g[layer], ln2_b[layer])
        y_prompt = encoder_layer(y_prompt, *p)
        y_sample = encoder_layer(y_sample, *p)
    return (y_prompt, y_sample)
```

```cpp
#include <hip/hip_runtime.h>
#include <hip/hip_cooperative_groups.h>
#include <cstdio>
#include <cstdint>
namespace cg = cooperative_groups;

#define LAS __attribute__((address_space(3)))
typedef unsigned short bf16_t;
typedef short bf16x8 __attribute__((ext_vector_type(8)));
typedef short s16x4 __attribute__((ext_vector_type(4)));
typedef float f32x4 __attribute__((ext_vector_type(4)));
typedef float f32x16 __attribute__((ext_vector_type(16)));
typedef unsigned u32x4 __attribute__((ext_vector_type(4)));
typedef unsigned u32x2 __attribute__((ext_vector_type(2)));

constexpr int SEQ = 8192, DM = 1024, FF = 4096;
constexpr int MP = 8 * SEQ, MS = 2 * SEQ, M = MP + MS;
constexpr int NB = M / SEQ;
constexpr int NIN = 5888;
constexpr int LDA_A = 2304, LDA_B = 1536, LDG = 2048, LDCAT = 768, LDAO = 768;
constexpr float LN_EPS = 1e-5f;
constexpr float ALPHA = 1.189207115002721f;
constexpr float LOG2E = 1.4426950408889634f;
constexpr float QSCALE = 0.125f * LOG2E;

constexpr size_t MiB = 1u << 20;
constexpr size_t WS_WIN = 0;
constexpr size_t WS_WB = 12 * MiB;
constexpr size_t WS_WA = 13 * MiB;
constexpr size_t WS_WO = 14 * MiB;
constexpr size_t WS_W1 = 16 * MiB;
constexpr size_t WS_W2 = 24 * MiB;
constexpr size_t WS_ROPE = 32 * MiB;
constexpr size_t WS_QKVA = 34 * MiB;
constexpr size_t WS_QKVB = WS_QKVA + 360 * MiB;
constexpr size_t WS_GATES = WS_QKVB + 240 * MiB;
constexpr size_t WS_END = WS_GATES + 320 * MiB;
constexpr size_t WS_ACAT = WS_QKVA;
constexpr size_t WS_MA = WS_QKVA + 120 * MiB;
constexpr size_t WS_MG = WS_QKVB;
constexpr size_t WS_X1B = WS_QKVA;
constexpr size_t WS_H = WS_QKVA + 160 * MiB;
static_assert(WS_H + 640 * MiB <= WS_END, "ws map");
constexpr size_t OUT_LSE = 120 * MiB;

constexpr int LDS_BYTES = 135168;

__device__ __forceinline__ unsigned cvt_pk_bf16(float lo, float hi) { unsigned r; asm volatile("v_cvt_pk_bf16_f32 %0, %1, %2" : "=v"(r) : "v"(lo), "v"(hi)); return r; }
__device__ __forceinline__ float bf_lo(unsigned w) { return __uint_as_float(w << 16); }
__device__ __forceinline__ float bf_hi(unsigned w) { return __uint_as_float(w & 0xffff0000u); }
__device__ __forceinline__ float wave_sum(float v) {
#pragma unroll
    for (int o = 1; o < 64; o <<= 1) v += __shfl_xor(v, o);
    return v;
}

namespace pg8 {
constexpr int BM = 256, BK = 64, HALF = 128, HTB = HALF * BK * 2, STAGE_BYTES = 8 * HTB, NXCD = 8, WGM = 8;
__host__ __device__ __forceinline__ int lds_byte(int r, int c) { const int st = (r >> 4) * 2 + (c >> 5), rr = r & 15, cc = c & 31, ob = rr * 64 + cc * 2; return st * 1024 + (ob ^ (((ob >> 9) & 1) << 5)); }
__host__ __device__ __forceinline__ void stage_rc(int b, int& R, int& C) { const int st = b / 1024, sb = b % 1024, swz = sb ^ (((sb >> 9) & 1) << 5); R = (st >> 1) * 16 + swz / 64; C = (st & 1) * 32 + (swz % 64) / 2; }
__host__ __device__ __forceinline__ int perm32(int rho) { const int n = rho >> 4, i = rho & 15; return 8 * (i >> 2) + 4 * n + (i & 3); }

struct Unit { int pm, pn; };
struct Gemm { const bf16_t* A; const bf16_t* Bt; int M, N, K, lda, ldb; };

struct StaticOrder {
    int nM, nN, nwg, G, c;
    __host__ __device__ void init(int M_, int N_, int G_, int c_) { nM = M_ / BM; nN = N_ / BM; nwg = nM * nN; G = G_; c = c_; }
    __host__ __device__ bool next(int i, Unit& u) const {
        const long L = (long)i * G + c; if (L >= nwg) return false;
        int wgid = (int)L; { const int q = nwg / NXCD, r = nwg % NXCD, xcd = wgid % NXCD, off = wgid / NXCD; wgid = (xcd < r ? xcd * (q + 1) : r * (q + 1) + (xcd - r) * q) + off; }
        const int nig = WGM * nN, gid = wgid / nig, fm = gid * WGM, gsz = (nM - fm) < WGM ? (nM - fm) : WGM;
        u.pm = fm + ((wgid % nig) % gsz); u.pn = (wgid % nig) / gsz; return true;
    }
};

template <class Epi, bool ALIGN_EPI>
__device__ __forceinline__ void gemm_phase(LAS unsigned char* lds, const Gemm g, const StaticOrder& S, const Epi& E) {
    const int tid = threadIdx.x, wid = __builtin_amdgcn_readfirstlane(tid >> 6), lane = tid & 63, wr = wid >> 2, wc = wid & 3, fr = lane & 15, fq = lane >> 4;
    const int K = g.K, nt = K / BK;
    unsigned voffA[2], voffB[2];
#pragma unroll
    for (int i = 0; i < 2; ++i) { int R, C; stage_rc(tid * 16 + i * 8192, R, C); const int Rb = Epi::PERM ? ((R & ~31) + perm32(R & 31)) : R;
        voffA[i] = (unsigned)(R * g.lda + C) * 2u; voffB[i] = (unsigned)(Rb * g.ldb + C) * 2u; }
    const size_t kstep = (size_t)(BK * 2);
    const size_t hstepA = (size_t)HALF * g.lda * 2, hstepB = (size_t)HALF * g.ldb * 2;
    const size_t tstepA = 2 * hstepA, tstepB = 2 * hstepB;
    const unsigned ldsw = (unsigned)wid * 1024u;
    const int aoff = lds_byte(wr * 64 + fr, fq * 8), boff = lds_byte(wc * 32 + fr, fq * 8);
#define PG8_SA(b, h) (((b) * 2 + (h)) * HTB)
#define PG8_SB(b, h) ((4 + (b) * 2 + (h)) * HTB)
#define PG8_STAGE(bufoff, gbase, voff) do { _Pragma("unroll") for (int _i = 0; _i < 2; ++_i) \
        __builtin_amdgcn_global_load_lds((const unsigned*)((const char*)(gbase) + (voff)[_i]), (LAS unsigned*)(lds + (bufoff) + ldsw + _i * 8192), 16, 0, 0); } while (0)
#define PG8_LDA(dst, b, h) do { _Pragma("unroll") for (int m = 0; m < 4; ++m) _Pragma("unroll") for (int k = 0; k < 2; ++k) dst[m][k] = *(const LAS bf16x8*)(lds + PG8_SA(b, h) + aoff + m * 2048 + k * 1024); } while (0)
#define PG8_LDB(dst, b, h) do { _Pragma("unroll") for (int n = 0; n < 2; ++n) _Pragma("unroll") for (int k = 0; k < 2; ++k) dst[n][k] = *(const LAS bf16x8*)(lds + PG8_SB(b, h) + boff + n * 2048 + k * 1024); } while (0)
#define PG8_MMA(ai, bj, At, Bt) do { __builtin_amdgcn_s_setprio(1); _Pragma("unroll") for (int m = 0; m < 4; ++m) _Pragma("unroll") for (int n = 0; n < 2; ++n) _Pragma("unroll") for (int k = 0; k < 2; ++k) \
        acc[ai][bj][m][n] = __builtin_amdgcn_mfma_f32_16x16x32_bf16(Bt[n][k], At[m][k], acc[ai][bj][m][n], 0, 0, 0); __builtin_amdgcn_s_setprio(0); } while (0)
#define PG8_WAIT_V(n) asm volatile("s_waitcnt vmcnt(" #n ")" ::: "memory")
#define PG8_WAIT_L(n) asm volatile("s_waitcnt lgkmcnt(" #n ")" ::: "memory")
#define PG8_BAR __builtin_amdgcn_s_barrier()
#define PG8_SCHED __builtin_amdgcn_sched_barrier(0)
    Unit cur, nxt; int ui = 0;
    if (!S.next(0, cur)) return;
    f32x4 acc[2][2][4][2];
#pragma unroll
    for (int a = 0; a < 2; ++a)
#pragma unroll
        for (int b = 0; b < 2; ++b)
#pragma unroll
            for (int m = 0; m < 4; ++m)
#pragma unroll
                for (int n = 0; n < 2; ++n) acc[a][b][m][n] = (f32x4){0.f, 0.f, 0.f, 0.f};
    bf16x8 At[4][2], B0[2][2], B1[2][2];
    const char* cA = (const char*)g.A + (size_t)cur.pm * tstepA; const char* cB = (const char*)g.Bt + (size_t)cur.pn * tstepB;
    PG8_STAGE(PG8_SB(0, 0), cB, voffB); PG8_STAGE(PG8_SB(0, 1), cB + hstepB, voffB); PG8_STAGE(PG8_SA(0, 0), cA, voffA); PG8_STAGE(PG8_SA(0, 1), cA + hstepA, voffA);
    if (wr == 1) PG8_BAR;
    PG8_WAIT_V(2); PG8_BAR;
    PG8_STAGE(PG8_SB(1, 0), cB + kstep, voffB); PG8_STAGE(PG8_SA(1, 0), cA + kstep, voffA); PG8_STAGE(PG8_SB(1, 1), cB + hstepB + kstep, voffB);
    PG8_WAIT_V(6); PG8_BAR;
    for (;;) {
        const bool has_next = S.next(ui + 1, nxt);
        const char* nA = has_next ? (const char*)g.A + (size_t)nxt.pm * tstepA : cA; const char* nB = has_next ? (const char*)g.Bt + (size_t)nxt.pn * tstepB : cB;
#pragma unroll 1
        for (int t = 0; t < nt; t += 2) {
            const bool last = (t == nt - 2);
            const char* a1 = cA + (size_t)(t + 1) * kstep;
            const char* a2 = last ? nA : cA + (size_t)(t + 2) * kstep; const char* b2 = last ? nB : cB + (size_t)(t + 2) * kstep;
            const char* a3 = a2 + kstep; const char* b3 = b2 + kstep;
            PG8_LDB(B0, 0, 0); PG8_LDB(B1, 0, 1); PG8_SCHED; PG8_LDA(At, 0, 0); PG8_STAGE(PG8_SA(1, 1), a1 + hstepA, voffA);
            PG8_WAIT_V(8); PG8_WAIT_L(0); PG8_BAR; PG8_MMA(0, 0, At, B0); PG8_MMA(0, 1, At, B1); PG8_BAR; PG8_SCHED;
            PG8_LDA(At, 0, 1); PG8_STAGE(PG8_SB(0, 0), b2, voffB); PG8_STAGE(PG8_SB(0, 1), b2 + hstepB, voffB); PG8_STAGE(PG8_SA(0, 0), a2, voffA);
            PG8_WAIT_V(8); PG8_WAIT_L(0); PG8_BAR; PG8_MMA(1, 0, At, B0); PG8_MMA(1, 1, At, B1); PG8_BAR; PG8_SCHED;
            PG8_LDB(B0, 1, 0); PG8_LDB(B1, 1, 1); PG8_SCHED; PG8_LDA(At, 1, 0); PG8_STAGE(PG8_SA(0, 1), a2 + hstepA, voffA);
            PG8_WAIT_V(8); PG8_WAIT_L(0); PG8_BAR; PG8_MMA(0, 0, At, B0); PG8_MMA(0, 1, At, B1); PG8_BAR; PG8_SCHED;
            PG8_LDA(At, 1, 1); PG8_STAGE(PG8_SB(1, 0), b3, voffB); PG8_STAGE(PG8_SB(1, 1), b3 + hstepB, voffB); PG8_STAGE(PG8_SA(1, 0), a3, voffA);
            PG8_WAIT_V(8); PG8_WAIT_L(0); PG8_BAR; PG8_MMA(1, 0, At, B0); PG8_MMA(1, 1, At, B1); PG8_BAR; PG8_SCHED;
        }
        if constexpr (ALIGN_EPI) { if (wr == 0) PG8_BAR; }
        E(acc, cur, wr, wc, fr, fq);
        if (!has_next) break;
#pragma unroll
        for (int a = 0; a < 2; ++a)
#pragma unroll
            for (int b = 0; b < 2; ++b)
#pragma unroll
                for (int m = 0; m < 4; ++m)
#pragma unroll
                    for (int n = 0; n < 2; ++n) acc[a][b][m][n] = (f32x4){0.f, 0.f, 0.f, 0.f};
        cur = nxt; cA = nA; cB = nB; ++ui;
        if constexpr (ALIGN_EPI) { if (wr == 1) PG8_BAR; }
    }
    PG8_WAIT_V(0);
    if constexpr (!ALIGN_EPI) { if (wr == 0) PG8_BAR; }
    PG8_BAR;
#undef PG8_SA
#undef PG8_SB
#undef PG8_STAGE
#undef PG8_LDA
#undef PG8_LDB
#undef PG8_MMA
#undef PG8_WAIT_V
#undef PG8_WAIT_L
#undef PG8_BAR
#undef PG8_SCHED
}
}
using pg8::Unit;

struct EpiProj {
    static constexpr bool PERM = true;
    bf16_t* qkva; bf16_t* qkvb; bf16_t* gates; const float* bgate; const float* rope;
    __device__ __forceinline__ void operator()(const f32x4 (&acc)[2][2][4][2], const Unit& u, int wr, int wc, int fr, int fq) const {
        const int pn = u.pn;
        bf16_t* base; int ld, colt, mode;
        if (pn < 9) { base = qkva; ld = LDA_A; colt = pn * 256; mode = pn < 3 ? 3 : (pn < 6 ? 2 : 0); }
        else if (pn < 15) { base = qkvb; ld = LDA_B; colt = (pn - 9) * 256; mode = pn < 11 ? 1 : 0; }
        else { base = gates; ld = LDG; colt = (pn - 15) * 256; mode = 4; }
        const int row0 = u.pm * 256 + wr * 64 + fr, cl = wc * 32 + 8 * fq;
        const bool do_rope = (mode & 2) && !(wc & 1);
        const float sc = (mode & 1) ? QSCALE : 1.f;
        f32x4 bv[2][2];
#pragma unroll
        for (int bj = 0; bj < 2; ++bj)
#pragma unroll
            for (int n = 0; n < 2; ++n) bv[bj][n] = (mode & 4) ? *(const f32x4*)(bgate + colt + bj * 128 + cl + 4 * n) : (f32x4){0.f, 0.f, 0.f, 0.f};
#pragma unroll
        for (int ai = 0; ai < 2; ++ai)
#pragma unroll
            for (int m = 0; m < 4; ++m) {
                const int row = row0 + ai * 128 + m * 16;
                f32x4 cs0, cs1, sn0, sn1;
                if (do_rope) { const float* rp = rope + (size_t)(row & (SEQ - 1)) * 16; cs0 = *(const f32x4*)(rp); cs1 = *(const f32x4*)(rp + 4); sn0 = *(const f32x4*)(rp + 8); sn1 = *(const f32x4*)(rp + 12);
                    if (fq == 0) { sn0 = -sn0; sn1 = -sn1; } }
                bf16_t* rowp = base + (size_t)row * ld + colt + cl;
#pragma unroll
                for (int bj = 0; bj < 2; ++bj) {
                    f32x4 v0 = acc[ai][bj][m][0], v1 = acc[ai][bj][m][1];
                    if (do_rope) {
                        f32x4 o0, o1;
#pragma unroll
                        for (int j = 0; j < 4; ++j) { o0[j] = __shfl_xor(v0[j], 16); o1[j] = __shfl_xor(v1[j], 16); }
                        if (fq < 2) { v0 = v0 * cs0 + o0 * sn0; v1 = v1 * cs1 + o1 * sn1; }
                    }
                    if (mode & 4) {
                        v0 = v0 + bv[bj][0]; v1 = v1 + bv[bj][1];
#pragma unroll
                        for (int j = 0; j < 4; ++j) { v0[j] = __builtin_amdgcn_rcpf(1.f + __builtin_amdgcn_exp2f(-LOG2E * v0[j])); v1[j] = __builtin_amdgcn_rcpf(1.f + __builtin_amdgcn_exp2f(-LOG2E * v1[j])); }
                    }
                    v0 = v0 * sc; v1 = v1 * sc;
                    u32x4 w; w.x = cvt_pk_bf16(v0[0], v0[1]); w.y = cvt_pk_bf16(v0[2], v0[3]); w.z = cvt_pk_bf16(v1[0], v1[1]); w.w = cvt_pk_bf16(v1[2], v1[3]);
                    *(u32x4*)(rowp + bj * 128) = w;
                }
                asm volatile("" ::: "memory");
            }
    }
};
template <bool ADD> struct EpiGate {
    static constexpr bool PERM = true;
    const bf16_t* gates; const bf16_t* prev; bf16_t* out;
    __device__ __forceinline__ void operator()(const f32x4 (&acc)[2][2][4][2], const Unit& u, int wr, int wc, int fr, int fq) const {
        const int row0 = u.pm * 256 + wr * 64 + fr, col0 = u.pn * 256 + wc * 32 + 8 * fq;
#pragma unroll
        for (int ai = 0; ai < 2; ++ai)
#pragma unroll
            for (int m = 0; m < 4; ++m) {
                const size_t row = (size_t)(row0 + ai * 128 + m * 16);
#pragma unroll
                for (int bj = 0; bj < 2; ++bj) {
                    const u32x4 gw = *(const u32x4*)(gates + row * LDG + col0 + bj * 128);
                    f32x4 v0 = acc[ai][bj][m][0], v1 = acc[ai][bj][m][1];
                    v0[0] *= bf_lo(gw.x); v0[1] *= bf_hi(gw.x); v0[2] *= bf_lo(gw.y); v0[3] *= bf_hi(gw.y);
                    v1[0] *= bf_lo(gw.z); v1[1] *= bf_hi(gw.z); v1[2] *= bf_lo(gw.w); v1[3] *= bf_hi(gw.w);
                    if (ADD) { const u32x4 pw = *(const u32x4*)(prev + row * DM + col0 + bj * 128);
                        v0[0] += bf_lo(pw.x); v0[1] += bf_hi(pw.x); v0[2] += bf_lo(pw.y); v0[3] += bf_hi(pw.y);
                        v1[0] += bf_lo(pw.z); v1[1] += bf_hi(pw.z); v1[2] += bf_lo(pw.w); v1[3] += bf_hi(pw.w); }
                    u32x4 w; w.x = cvt_pk_bf16(v0[0], v0[1]); w.y = cvt_pk_bf16(v0[2], v0[3]); w.z = cvt_pk_bf16(v1[0], v1[1]); w.w = cvt_pk_bf16(v1[2], v1[3]);
                    *(u32x4*)(out + row * DM + col0 + bj * 128) = w;
                }
                asm volatile("" ::: "memory");
            }
    }
};
struct EpiRes {
    static constexpr bool PERM = false;
    const float* xp; const float* xs; float* out; const float* bias;
    __device__ __forceinline__ void operator()(const f32x4 (&acc)[2][2][4][2], const Unit& u, int wr, int wc, int fr, int fq) const {
        const int rowt = u.pm * 256; const float* src = rowt < MP ? xp + (size_t)rowt * DM : xs + (size_t)(rowt - MP) * DM;
        float* dst = out + (size_t)rowt * DM;
        const int rl0 = wr * 64 + fr, col0 = u.pn * 256 + wc * 32 + 4 * fq;
        f32x4 bv[2][2];
#pragma unroll
        for (int bj = 0; bj < 2; ++bj)
#pragma unroll
            for (int n = 0; n < 2; ++n) bv[bj][n] = bias ? *(const f32x4*)(bias + col0 + bj * 128 + n * 16) : (f32x4){0.f, 0.f, 0.f, 0.f};
#pragma unroll
        for (int ai = 0; ai < 2; ++ai)
#pragma unroll
            for (int m = 0; m < 4; ++m) {
                const size_t off = (size_t)(rl0 + ai * 128 + m * 16) * DM + col0;
#pragma unroll
                for (int bj = 0; bj < 2; ++bj)
#pragma unroll
                    for (int n = 0; n < 2; ++n) { const f32x4 xv = *(const f32x4*)(src + off + bj * 128 + n * 16);
                        *(f32x4*)(dst + off + bj * 128 + n * 16) = xv * ALPHA + acc[ai][bj][m][n] + bv[bj][n]; }
                asm volatile("" ::: "memory");
            }
    }
};
struct EpiRelu2 {
    static constexpr bool PERM = true;
    bf16_t* out; const float* bias;
    __device__ __forceinline__ void operator()(const f32x4 (&acc)[2][2][4][2], const Unit& u, int wr, int wc, int fr, int fq) const {
        const int row0 = u.pm * 256 + wr * 64 + fr, col0 = u.pn * 256 + wc * 32 + 8 * fq;
        f32x4 bv[2][2];
#pragma unroll
        for (int bj = 0; bj < 2; ++bj)
#pragma unroll
            for (int n = 0; n < 2; ++n) bv[bj][n] = *(const f32x4*)(bias + col0 + bj * 128 + 4 * n);
#pragma unroll
        for (int ai = 0; ai < 2; ++ai)
#pragma unroll
            for (int m = 0; m < 4; ++m) {
                bf16_t* rowp = out + (size_t)(row0 + ai * 128 + m * 16) * FF + col0;
#pragma unroll
                for (int bj = 0; bj < 2; ++bj) {
                    f32x4 v0 = acc[ai][bj][m][0] + bv[bj][0], v1 = acc[ai][bj][m][1] + bv[bj][1];
#pragma unroll
                    for (int j = 0; j < 4; ++j) { const float a = fmaxf(v0[j], 0.f), b = fmaxf(v1[j], 0.f); v0[j] = a * a; v1[j] = b * b; }
                    u32x4 w; w.x = cvt_pk_bf16(v0[0], v0[1]); w.y = cvt_pk_bf16(v0[2], v0[3]); w.z = cvt_pk_bf16(v1[0], v1[1]); w.w = cvt_pk_bf16(v1[2], v1[3]);
                    *(u32x4*)(rowp + bj * 128) = w;
                }
            }
    }
};

__device__ __forceinline__ s16x4 vtr(const LAS unsigned char* p) { return __builtin_bit_cast(s16x4, __builtin_amdgcn_ds_read_tr16_b64_v4i16((LAS s16x4*)p)); }
__device__ __forceinline__ int crow(int r, int hi) { return (r & 3) + 8 * (r >> 2) + 4 * hi; }
__device__ __forceinline__ void softmax_pv_tile(f32x16& s, float& mrun, float& lrun, f32x16 (&o)[2], const LAS unsigned char* vb, int vplane) {
    float tm = s[0];
#pragma unroll
    for (int r = 1; r < 16; ++r) tm = fmaxf(tm, s[r]);
    tm = fmaxf(tm, __shfl_xor(tm, 32));
    const float mn = fmaxf(mrun, tm);
    const float sc = __builtin_amdgcn_exp2f(mrun - mn);
    mrun = mn; lrun *= sc;
#pragma unroll
    for (int r = 0; r < 16; ++r) { o[0][r] *= sc; o[1][r] *= sc; }
    float ps = 0.f;
#pragma unroll
    for (int r = 0; r < 16; ++r) { s[r] = __builtin_amdgcn_exp2f(s[r] - mn); ps += s[r]; }
    lrun += ps;
    u32x4 pw0, pw1;
    pw0.x = cvt_pk_bf16(s[0], s[1]); pw0.y = cvt_pk_bf16(s[2], s[3]); pw0.z = cvt_pk_bf16(s[4], s[5]); pw0.w = cvt_pk_bf16(s[6], s[7]);
    pw1.x = cvt_pk_bf16(s[8], s[9]); pw1.y = cvt_pk_bf16(s[10], s[11]); pw1.z = cvt_pk_bf16(s[12], s[13]); pw1.w = cvt_pk_bf16(s[14], s[15]);
    const bf16x8 p0 = __builtin_bit_cast(bf16x8, pw0), p1 = __builtin_bit_cast(bf16x8, pw1);
#pragma unroll
    for (int dh = 0; dh < 2; ++dh) {
        const LAS unsigned char* vp = vb + dh * vplane;
        const s16x4 a0 = vtr(vp), a1 = vtr(vp + 512), b0 = vtr(vp + 1024), b1 = vtr(vp + 1536);
        const bf16x8 va = (bf16x8){a0[0], a0[1], a0[2], a0[3], a1[0], a1[1], a1[2], a1[3]};
        const bf16x8 vb8 = (bf16x8){b0[0], b0[1], b0[2], b0[3], b1[0], b1[1], b1[2], b1[3]};
        o[dh] = __builtin_amdgcn_mfma_f32_32x32x16_bf16(va, p0, o[dh], 0, 0, 0);
        o[dh] = __builtin_amdgcn_mfma_f32_32x32x16_bf16(vb8, p1, o[dh], 0, 0, 0);
    }
}
__device__ __forceinline__ void store_o(const f32x16 (&o)[2], float inv, bf16_t* dst, int hi) {
#pragma unroll
    for (int dh = 0; dh < 2; ++dh)
#pragma unroll
        for (int i = 0; i < 4; ++i) { u32x2 w; w.x = cvt_pk_bf16(o[dh][4 * i] * inv, o[dh][4 * i + 1] * inv); w.y = cvt_pk_bf16(o[dh][4 * i + 2] * inv, o[dh][4 * i + 3] * inv);
            *(u32x2*)(dst + 32 * dh + 8 * i + 4 * hi) = w; }
}

constexpr int A_NK = 384, A_KPLANE = (A_NK + 1) * 16, A_VPLANE = A_NK * 64 + 64, A_VOFF = 8 * A_KPLANE;
static_assert(A_VOFF + 2 * A_VPLANE <= 131072, "attn A lds");
__device__ __forceinline__ void attnA_unit(LAS unsigned char* lds, int unit, const bf16_t* qkva, bf16_t* ao, float* lse) {
    const int tid = threadIdx.x, lane = tid & 63, w = __builtin_amdgcn_readfirstlane(tid >> 6), r32 = lane & 31, hi = lane >> 5;
    const int x = unit & 31, hd = (unit >> 5) % 12, b = unit / (32 * 12);
    const int g = hd >> 2, lgd = 2 * g, d = 1 << lgd, L = SEQ >> lgd, nblk = L >> 8;
    const int res = x / nblk, n = x % nblk;
    const size_t rowb = (size_t)b * SEQ;
    __syncthreads();
#pragma unroll
    for (int it = 0; it < 6; ++it) {
        const int id = tid + 512 * it, key = id >> 3, ch = id & 7, sp = 256 * n - 64 + key;
        u32x4 kv = (u32x4){0u, 0u, 0u, 0u}, vv = kv;
        if (sp >= 0 && sp < L) { const bf16_t* p = qkva + (rowb + (size_t)sp * d + res) * LDA_A + hd * 64 + ch * 8; kv = *(const u32x4*)(p + 768); vv = *(const u32x4*)(p + 1536); }
        *(LAS u32x4*)(lds + ch * A_KPLANE + key * 16) = kv;
        *(LAS u32x4*)(lds + A_VOFF + (ch >> 2) * A_VPLANE + key * 64 + (ch & 3) * 16) = vv;
    }
    const int q0 = 256 * n + 32 * w;
    const size_t qrow = rowb + (size_t)(q0 + r32) * d + res;
    bf16x8 qf[4];
#pragma unroll
    for (int d0 = 0; d0 < 4; ++d0) qf[d0] = *(const bf16x8*)(qkva + qrow * LDA_A + hd * 64 + 16 * d0 + 8 * hi);
    __syncthreads();
    float mrun = -1e30f, lrun = 0.f; f32x16 o[2];
#pragma unroll
    for (int r = 0; r < 16; ++r) { o[0][r] = 0.f; o[1][r] = 0.f; }
    const LAS unsigned char* kb = lds + hi * A_KPLANE + (32 * w + r32) * 16;
    const LAS unsigned char* vb = lds + A_VOFF + (32 * w + 4 * hi + ((lane & 15) >> 2)) * 64 + ((lane >> 4) & 1) * 32 + (lane & 3) * 8;
#pragma unroll
    for (int j = 0; j < 5; ++j) {
        f32x16 s;
#pragma unroll
        for (int r = 0; r < 16; ++r) s[r] = 0.f;
#pragma unroll
        for (int d0 = 0; d0 < 4; ++d0) { const bf16x8 kf = *(const LAS bf16x8*)(kb + 2 * d0 * A_KPLANE + j * 512); s = __builtin_amdgcn_mfma_f32_32x32x16_bf16(kf, qf[d0], s, 0, 0, 0); }
#pragma unroll
        for (int r = 0; r < 16; ++r) { const int kk = 32 * j + crow(r, hi), off = kk - 64 - r32, ksp = q0 - 64 + kk;
            const bool ok = (off >= -64) && (off <= 64) && (ksp >= 0) && (ksp < L); s[r] = ok ? s[r] : -INFINITY; }
        softmax_pv_tile(s, mrun, lrun, o, vb + j * 2048, A_VPLANE);
    }
    const float lt = lrun + __shfl_xor(lrun, 32);
    store_o(o, 1.0f / lt, ao + qrow * LDAO + hd * 64, hi);
    if (hi == 0) lse[qrow * 12 + hd] = mrun + __builtin_amdgcn_logf(lt);
}

constexpr int B_NK = 480, B_VPLANE = B_NK * 64 + 64, B_HALF = 2 * B_VPLANE, B_BIAS = 2 * B_HALF;
static_assert(B_BIAS + 2 * 2048 <= 131072, "attn B lds");
__device__ __forceinline__ void attnB_unit(LAS unsigned char* lds, int unit, const bf16_t* qkvb, const float* rpb, bf16_t* acat) {
    const int tid = threadIdx.x, lane = tid & 63, wid = __builtin_amdgcn_readfirstlane(tid >> 6), hf = wid >> 2, w = wid & 3, r32 = lane & 31, hi = lane >> 5;
    const int hp = unit & 3, cb = (unit >> 2) & 3, rb = (unit >> 4) & 15, b = unit >> 8;
    const int h = 2 * hp + hf;
    const size_t rowb = (size_t)b * SEQ;
    int kr0 = 8 * rb - 4; kr0 = kr0 < 0 ? 0 : (kr0 > 113 ? 113 : kr0);
    int kc0 = 16 * cb - 8; kc0 = kc0 < 0 ? 0 : (kc0 > 32 ? 32 : kc0);
    LAS unsigned char* vs = lds + hf * B_HALF;
    LAS float* bt = (LAS float*)(lds + B_BIAS + hf * 2048);
    __syncthreads();
    const int ht = tid & 255;
#pragma unroll
    for (int it = 0; it < 15; ++it) {
        const int id = ht + 256 * it, key = id >> 3, ch = id & 7;
        const size_t grow = rowb + (size_t)(kr0 + (key >> 5)) * 64 + kc0 + (key & 31);
        const u32x4 vv = *(const u32x4*)(qkvb + grow * LDA_B + 1024 + h * 64 + ch * 8);
        *(LAS u32x4*)(vs + (ch >> 2) * B_VPLANE + key * 64 + (ch & 3) * 16) = vv;
    }
    for (int i = ht; i < 465; i += 256) bt[i] = rpb[h * 465 + i] * LOG2E;
    const int qr = r32 >> 4, qc = r32 & 15, r = 8 * rb + 2 * w + qr, c = 16 * cb + qc;
    const size_t qrow = rowb + (size_t)r * 64 + c;
    bf16x8 qf[4];
#pragma unroll
    for (int d0 = 0; d0 < 4; ++d0) qf[d0] = *(const bf16x8*)(qkvb + qrow * LDA_B + h * 64 + 16 * d0 + 8 * hi);
    int wr_ = r - 4; wr_ = wr_ < 0 ? 0 : (wr_ > 120 ? 120 : wr_);
    int wc_ = c - 8; wc_ = wc_ < 0 ? 0 : (wc_ > 48 ? 48 : wc_);
    int wr0 = 8 * rb + 2 * w - 4; wr0 = wr0 < 0 ? 0 : (wr0 > 120 ? 120 : wr0);
    int i0 = wr0 - kr0; i0 = i0 > 6 ? 6 : i0;
    const bf16_t* kbase = qkvb + (rowb + (size_t)(kr0 + i0) * 64 + kc0 + r32) * LDA_B + 512 + h * 64 + 8 * hi;
    bf16x8 kf[4];
#pragma unroll
    for (int d0 = 0; d0 < 4; ++d0) kf[d0] = *(const bf16x8*)(kbase + 16 * d0);
    __syncthreads();
    float mrun = -1e30f, lrun = 0.f; f32x16 o[2];
#pragma unroll
    for (int rr = 0; rr < 16; ++rr) { o[0][rr] = 0.f; o[1][rr] = 0.f; }
    const LAS unsigned char* vb = vs + (i0 * 32 + 4 * hi + ((lane & 15) >> 2)) * 64 + ((lane >> 4) & 1) * 32 + (lane & 3) * 8;
    const int dcb = kc0 - c + 15;
#pragma unroll 1
    for (int j = 0; j < 9; ++j) {
        f32x16 s;
#pragma unroll
        for (int rr = 0; rr < 16; ++rr) s[rr] = 0.f;
#pragma unroll
        for (int d0 = 0; d0 < 4; ++d0) s = __builtin_amdgcn_mfma_f32_32x32x16_bf16(kf[d0], qf[d0], s, 0, 0, 0);
        if (j < 8) {
#pragma unroll
            for (int d0 = 0; d0 < 4; ++d0) kf[d0] = *(const bf16x8*)(kbase + (size_t)(j + 1) * 64 * LDA_B + 16 * d0);
        }
        const int kr = kr0 + i0 + j;
        const bool okr = (kr >= wr_) && (kr < wr_ + 8);
        int dr = kr - r + 7; dr = dr < 0 ? 0 : (dr > 14 ? 14 : dr);
#pragma unroll
        for (int rr = 0; rr < 16; ++rr) { const int kk = crow(rr, hi), kc = kc0 + kk; int dc = dcb + kk; dc = dc < 0 ? 0 : (dc > 30 ? 30 : dc);
            const bool ok = okr && (kc >= wc_) && (kc < wc_ + 16);
            const float bias = bt[dr * 31 + dc];
            s[rr] = ok ? s[rr] + bias : -INFINITY; }
        softmax_pv_tile(s, mrun, lrun, o, vb + j * 2048, B_VPLANE);
    }
    const float lt = lrun + __shfl_xor(lrun, 32);
    store_o(o, 1.0f / lt, acat + qrow * LDCAT + h * 64, hi);
}

__device__ __forceinline__ void p0_transpose_item(const float* W, int K, int N, bf16_t* WT, LAS float* scr, int item, int lane) {
    const int nblk = N / 32, kb = item / nblk, nb = item % nblk, k0 = 64 * kb, n0 = 32 * nb;
#pragma unroll 8
    for (int i = 0; i < 32; ++i) { const int kk = 2 * i + (lane >> 5); scr[kk * 33 + (lane & 31)] = W[(size_t)(k0 + kk) * N + n0 + (lane & 31)]; }
    asm volatile("s_waitcnt lgkmcnt(0)" ::: "memory");
    const int c = lane & 7;
#pragma unroll
    for (int j = 0; j < 4; ++j) { const int n = (lane >> 3) + 8 * j; const LAS float* s = scr + (8 * c) * 33 + n;
        u32x4 o; o.x = cvt_pk_bf16(s[0 * 33], s[1 * 33]); o.y = cvt_pk_bf16(s[2 * 33], s[3 * 33]); o.z = cvt_pk_bf16(s[4 * 33], s[5 * 33]); o.w = cvt_pk_bf16(s[6 * 33], s[7 * 33]);
        *(u32x4*)(WT + (size_t)(n0 + n) * K + k0 + 8 * c) = o; }
    asm volatile("s_waitcnt lgkmcnt(0)" ::: "memory");
}

struct Args {
    const float* in[16]; float* out; unsigned char* ws; int ph_lo, ph_hi;
};
constexpr int NPHASE = 11;

__global__ void __launch_bounds__(512, 2) mega(Args a) {
    extern __shared__ __attribute__((aligned(16))) unsigned char lds_raw[];
    LAS unsigned char* lds = (LAS unsigned char*)lds_raw;
    cg::grid_group grid = cg::this_grid();
    const int tid = threadIdx.x, lane = tid & 63, wave = __builtin_amdgcn_readfirstlane(tid >> 6);
    const int G = gridDim.x, bid = blockIdx.x;
    const int gw = bid * 8 + wave, NGW = G * 8;
    const float* xp = a.in[0]; const float* xs = a.in[1];
    unsigned char* ws = a.ws;
    bf16_t* WinT = (bf16_t*)(ws + WS_WIN); bf16_t* WbT = (bf16_t*)(ws + WS_WB); bf16_t* WaT = (bf16_t*)(ws + WS_WA); bf16_t* WoT = (bf16_t*)(ws + WS_WO);
    bf16_t* W1T = (bf16_t*)(ws + WS_W1); bf16_t* W2T = (bf16_t*)(ws + WS_W2); float* rope = (float*)(ws + WS_ROPE);
    bf16_t* QKVA = (bf16_t*)(ws + WS_QKVA); bf16_t* QKVB = (bf16_t*)(ws + WS_QKVB); bf16_t* GATES = (bf16_t*)(ws + WS_GATES);
    bf16_t* ACAT = (bf16_t*)(ws + WS_ACAT); bf16_t* MA = (bf16_t*)(ws + WS_MA); bf16_t* MG = (bf16_t*)(ws + WS_MG); bf16_t* X1B = (bf16_t*)(ws + WS_X1B); bf16_t* HB = (bf16_t*)(ws + WS_H);
    bf16_t* XB = (bf16_t*)a.out; bf16_t* AO = (bf16_t*)a.out; float* LSE = (float*)((unsigned char*)a.out + OUT_LSE);
    const int lo = a.ph_lo, hi_ = a.ph_hi;
#ifndef PHMASK
#define PHMASK 0x7ff
#endif
#define IN(k) (((PHMASK >> (k)) & 1) && lo <= (k) && (k) < hi_)
#define SEAM(k) do { if (IN(k) && IN((k) + 1)) grid.sync(); } while (0)

    if (IN(0)) {
        LAS float* scr = (LAS float*)(lds + wave * 16384);
        constexpr int I_IN = 16 * 184, I_B = 8 * 32, I_A = 4 * 32, I_O = 16 * 32, I_1 = 16 * 128, I_2 = 64 * 32;
        constexpr int NITEMS = I_IN + I_B + I_A + I_O + I_1 + I_2;
        for (int it = gw; it < NITEMS; it += NGW) {
            int r = it;
            if (r < I_IN) { p0_transpose_item(a.in[2], 1024, NIN, WinT, scr, r, lane); continue; } r -= I_IN;
            if (r < I_B) { p0_transpose_item(a.in[5], 512, 1024, WbT, scr, r, lane); continue; } r -= I_B;
            if (r < I_A) { p0_transpose_item(a.in[4], 256, 1024, WaT, scr, r, lane); continue; } r -= I_A;
            if (r < I_O) { p0_transpose_item(a.in[6], 1024, 1024, WoT, scr, r, lane); continue; } r -= I_O;
            if (r < I_1) { p0_transpose_item(a.in[10], 1024, FF, W1T, scr, r, lane); continue; } r -= I_1;
            p0_transpose_item(a.in[12], FF, 1024, W2T, scr, r, lane);
        }
        for (int m = gw; m < M; m += NGW) {
            const float* src = m < MP ? xp + (size_t)m * DM : xs + (size_t)(m - MP) * DM;
            const f32x4* xr = (const f32x4*)src + lane; u32x2* o8 = (u32x2*)(XB + (size_t)m * DM) + lane;
#pragma unroll
            for (int j = 0; j < 4; ++j) { const f32x4 v = xr[64 * j]; u32x2 w; w.x = cvt_pk_bf16(v[0], v[1]); w.y = cvt_pk_bf16(v[2], v[3]); o8[64 * j] = w; }
        }
        for (int idx = bid * 512 + tid; idx < SEQ * 8; idx += G * 512) {
            const int t = idx >> 3, i = idx & 7;
            const float inv = (float)exp2(-(double)i * (18.931568569324174 / 8.0));
            const float ang = (float)t * inv;
            const double rev = (double)ang * 0.15915494309189535; const float fr = (float)(rev - floor(rev));
            rope[t * 16 + i] = __builtin_amdgcn_cosf(fr); rope[t * 16 + 8 + i] = __builtin_amdgcn_sinf(fr);
        }
    }
    SEAM(0);
    if (IN(1)) {
        pg8::Gemm g{XB, WinT, M, NIN, DM, DM, DM}; pg8::StaticOrder S; S.init(M, NIN, G, bid);
        EpiProj E{QKVA, QKVB, GATES, a.in[3], rope};
        pg8::gemm_phase<EpiProj, true>(lds, g, S, E);
    }
    SEAM(1);
    if (IN(2)) {
        for (int u = bid; u < NB * 12 * 32; u += G) attnA_unit(lds, u, QKVA, AO, LSE);
        __syncthreads();
    }
    SEAM(2);
    if (IN(3)) {
        for (int u = bid; u < NB * 256; u += G) attnB_unit(lds, u, QKVB, a.in[7], ACAT);
        __syncthreads();
        for (int m = gw; m < M; m += NGW) {
            const int hs = lane >> 4, d4 = (lane & 15) * 4;
            const float l0 = LSE[(size_t)m * 12 + hs], l1 = LSE[(size_t)m * 12 + 4 + hs], l2 = LSE[(size_t)m * 12 + 8 + hs];
            const float mx = fmaxf(l0, fmaxf(l1, l2));
            float w0 = __builtin_amdgcn_exp2f(l0 - mx), w1 = __builtin_amdgcn_exp2f(l1 - mx), w2 = __builtin_amdgcn_exp2f(l2 - mx);
            const float inv = 1.0f / (w0 + w1 + w2); w0 *= inv; w1 *= inv; w2 *= inv;
            const bf16_t* p = AO + (size_t)m * LDAO + hs * 64 + d4;
            const u32x2 a0 = *(const u32x2*)(p), a1 = *(const u32x2*)(p + 256), a2 = *(const u32x2*)(p + 512);
            const float r0 = w0 * bf_lo(a0.x) + w1 * bf_lo(a1.x) + w2 * bf_lo(a2.x), r1 = w0 * bf_hi(a0.x) + w1 * bf_hi(a1.x) + w2 * bf_hi(a2.x);
            const float r2 = w0 * bf_lo(a0.y) + w1 * bf_lo(a1.y) + w2 * bf_lo(a2.y), r3 = w0 * bf_hi(a0.y) + w1 * bf_hi(a1.y) + w2 * bf_hi(a2.y);
            u32x2 wv; wv.x = cvt_pk_bf16(r0, r1); wv.y = cvt_pk_bf16(r2, r3);
            *(u32x2*)(ACAT + (size_t)m * LDCAT + 512 + hs * 64 + d4) = wv;
        }
    }
    SEAM(3);
    if (IN(4)) {
        pg8::Gemm g{ACAT + 512, WaT, M, DM, 256, LDCAT, 256}; pg8::StaticOrder S; S.init(M, DM, G, bid);
        EpiGate<false> E{GATES, nullptr, MA};
        pg8::gemm_phase<EpiGate<false>, true>(lds, g, S, E);
    }
    SEAM(4);
    if (IN(5)) {
        pg8::Gemm g{ACAT, WbT, M, DM, 512, LDCAT, 512}; pg8::StaticOrder S; S.init(M, DM, G, bid);
        EpiGate<true> E{GATES + 1024, MA, MG};
        pg8::gemm_phase<EpiGate<true>, true>(lds, g, S, E);
    }
    SEAM(5);
    if (IN(6)) {
        pg8::Gemm g{MG, WoT, M, DM, DM, DM, DM}; pg8::StaticOrder S; S.init(M, DM, G, bid);
        EpiRes E{xp, xs, a.out, nullptr};
        pg8::gemm_phase<EpiRes, true>(lds, g, S, E);
    }
    SEAM(6);
    if (IN(7)) {
        const float* gam = a.in[8]; const float* bet = a.in[9];
        f32x4 gv[4], bv[4];
#pragma unroll
        for (int j = 0; j < 4; ++j) { gv[j] = ((const f32x4*)gam)[64 * j + lane]; bv[j] = ((const f32x4*)bet)[64 * j + lane]; }
        for (int m = gw; m < M; m += NGW) {
            f32x4* xr = (f32x4*)(a.out + (size_t)m * DM) + lane; f32x4 v[4]; float s = 0.f;
#pragma unroll
            for (int j = 0; j < 4; ++j) { v[j] = xr[64 * j]; s += (v[j][0] + v[j][1]) + (v[j][2] + v[j][3]); }
            const float mean = wave_sum(s) * (1.f / DM); float s2 = 0.f;
#pragma unroll
            for (int j = 0; j < 4; ++j) { v[j] = v[j] - mean; s2 += (v[j][0] * v[j][0] + v[j][1] * v[j][1]) + (v[j][2] * v[j][2] + v[j][3] * v[j][3]); }
            const float rstd = 1.0f / sqrtf(wave_sum(s2) * (1.f / DM) + LN_EPS);
            u32x2* o8 = (u32x2*)(X1B + (size_t)m * DM) + lane;
#pragma unroll
            for (int j = 0; j < 4; ++j) { const f32x4 y = v[j] * rstd * gv[j] + bv[j]; xr[64 * j] = y; u32x2 w; w.x = cvt_pk_bf16(y[0], y[1]); w.y = cvt_pk_bf16(y[2], y[3]); o8[64 * j] = w; }
        }
    }
    SEAM(7);
    if (IN(8)) {
        pg8::Gemm g{X1B, W1T, M, FF, DM, DM, DM}; pg8::StaticOrder S; S.init(M, FF, G, bid);
        EpiRelu2 E{HB, a.in[11]};
        pg8::gemm_phase<EpiRelu2, true>(lds, g, S, E);
    }
    SEAM(8);
    if (IN(9)) {
        pg8::Gemm g{HB, W2T, M, DM, FF, FF, FF}; pg8::StaticOrder S; S.init(M, DM, G, bid);
        EpiRes E{a.out, a.out + (size_t)MP * DM, a.out, a.in[13]};
        pg8::gemm_phase<EpiRes, true>(lds, g, S, E);
    }
    SEAM(9);
    if (IN(10)) {
        const float* gam = a.in[14]; const float* bet = a.in[15];
        f32x4 gv[4], bv[4];
#pragma unroll
        for (int j = 0; j < 4; ++j) { gv[j] = ((const f32x4*)gam)[64 * j + lane]; bv[j] = ((const f32x4*)bet)[64 * j + lane]; }
        for (int m = gw; m < M; m += NGW) {
            f32x4* xr = (f32x4*)(a.out + (size_t)m * DM) + lane; f32x4 v[4]; float s = 0.f;
#pragma unroll
            for (int j = 0; j < 4; ++j) { v[j] = xr[64 * j]; s += (v[j][0] + v[j][1]) + (v[j][2] + v[j][3]); }
            const float mean = wave_sum(s) * (1.f / DM); float s2 = 0.f;
#pragma unroll
            for (int j = 0; j < 4; ++j) { v[j] = v[j] - mean; s2 += (v[j][0] * v[j][0] + v[j][1] * v[j][1]) + (v[j][2] * v[j][2] + v[j][3] * v[j][3]); }
            const float rstd = 1.0f / sqrtf(wave_sum(s2) * (1.f / DM) + LN_EPS);
#pragma unroll
            for (int j = 0; j < 4; ++j) xr[64 * j] = v[j] * rstd * gv[j] + bv[j];
        }
    }
#undef IN
#undef SEAM
}

extern "C" void kernel_launch(void* const* d_in, const int* in_sizes, int n_in, void* d_out, int out_size, void* d_ws, size_t ws_size, hipStream_t stream) {
    static int grid = 0;
    if (grid == 0) {
        if (n_in != 16 || out_size != M * DM || ws_size < WS_END) { fprintf(stderr, "kernel_launch: unexpected shapes (n_in %d out %d ws %zu)\n", n_in, out_size, ws_size); grid = -1; return; }
        int dev = 0, cus = 0, per_cu = 0;
        hipGetDevice(&dev);
        hipDeviceGetAttribute(&cus, hipDeviceAttributeMultiprocessorCount, dev);
        if (hipFuncSetAttribute((const void*)mega, hipFuncAttributeMaxDynamicSharedMemorySize, LDS_BYTES) != hipSuccess) { fprintf(stderr, "kernel_launch: hipFuncSetAttribute failed\n"); grid = -1; return; }
        hipOccupancyMaxActiveBlocksPerMultiprocessor(&per_cu, (const void*)mega, 512, LDS_BYTES);
        (void)hipGetLastError();
        if (per_cu < 1) per_cu = 1;
        grid = cus * 1;
        fprintf(stderr, "kernel_launch: cus %d per_cu %d grid %d\n", cus, per_cu, grid);
    }
    if (grid < 0) return;
    Args a{};
    for (int i = 0; i < 16; ++i) a.in[i] = (const float*)d_in[i];
    a.out = (float*)d_out; a.ws = (unsigned char*)d_ws; a.ph_lo = 0; a.ph_hi = NPHASE;
    void* args[] = {&a};
    hipError_t e = hipLaunchCooperativeKernel((const void*)mega, dim3(grid), dim3(512), args, LDS_BYTES, stream);
    if (e != hipSuccess) fprintf(stderr, "cooperative launch failed: %s (grid %d)\n", hipGetErrorString(e), grid);
}
```
